# Optimizing an MI355X kernel written in HIP

```python
import jax, jax.numpy as jnp
from jax import lax
import numpy as np

D_MODEL = 1024
BATCH = 4
SEQ = 8192
DEPTH = 2

CHUNK = 64
NORM_EPS = 1e-6
A_HEADS = 8
A_HEAD_DIM = 64
A_WIDTH = A_HEADS * A_HEAD_DIM
A_LEFT_CHUNKS = 8
A_BAND = (A_LEFT_CHUNKS + 1) * CHUNK
A_MAX_REL = 256
B_GROUPS = 4
B_BLOCK = 128
B_WIDTH = D_MODEL // 2
B_GROUP_DIM = B_WIDTH // B_GROUPS
AB_IN = 3 * A_WIDTH + 2 * B_WIDTH
AB_MIX = A_WIDTH + B_WIDTH
C_HEADS = 4
C_KEY_DIM = D_MODEL // 2
C_VAL_DIM = D_MODEL
C_DK = C_KEY_DIM // C_HEADS
C_DV = C_VAL_DIM // C_HEADS
C_GATE_RANK = 16
C_GATE_TAU = 16.0
C_IN = 2 * C_KEY_DIM + 2 * C_VAL_DIM + C_GATE_RANK
D_FF = ((-(-8 * D_MODEL // 3) + 255) // 256) * 256
N_EVEN = (DEPTH + 1) // 2
N_ODD = DEPTH // 2

kernel_name = "hybrid_chunk_attn_gmlp_gla"


def rms_norm(x, g):
    xf = x.astype(jnp.float32)
    y = xf * lax.rsqrt(jnp.mean(xf * xf, axis=-1, keepdims=True) + NORM_EPS)
    return (y * g.astype(jnp.float32)).astype(x.dtype)


def layer_norm(x, g, b):
    xf = x.astype(jnp.float32)
    mu = jnp.mean(xf, axis=-1, keepdims=True)
    var = jnp.mean(jnp.square(xf - mu), axis=-1, keepdims=True)
    y = (xf - mu) * lax.rsqrt(var + NORM_EPS)
    return (y * g.astype(jnp.float32) + b.astype(jnp.float32)).astype(x.dtype)


def chunk_band_attention(q, k, v, rel_bias):
    b, s, h, d = q.shape
    nc = s // CHUNK
    f32 = jnp.float32
    qc = q.reshape(b, nc, CHUNK, h, d).astype(f32) * (d ** -0.5)
    pad = ((0, 0), (A_LEFT_CHUNKS, 0), (0, 0), (0, 0), (0, 0))
    kp = jnp.pad(k.reshape(b, nc, CHUNK, h, d), pad)
    vp = jnp.pad(v.reshape(b, nc, CHUNK, h, d), pad)
    idx = jnp.arange(nc)[:, None] + jnp.arange(A_LEFT_CHUNKS + 1)[None, :]
    kb = kp[:, idx].reshape(b, nc, A_BAND, h, d).astype(f32)
    vb = vp[:, idx].reshape(b, nc, A_BAND, h, d).astype(f32)
    scores = jnp.einsum('bcqhd,bckhd->bhcqk', qc, kb)
    qi = jnp.arange(CHUNK)[:, None]
    kj = jnp.arange(A_BAND)[None, :]
    rel = jnp.clip(qi + A_LEFT_CHUNKS * CHUNK - kj, -A_MAX_REL, A_MAX_REL) + A_MAX_REL
    bias = rel_bias.astype(f32)[:, rel]
    valid = jnp.repeat((idx - A_LEFT_CHUNKS) >= 0, CHUNK, axis=1)
    scores = jnp.where(valid[None, None, :, None, :], scores + bias[None, :, None],
                       jnp.finfo(f32).min)
    p = jax.nn.softmax(scores, axis=-1)
    out = jnp.einsum('bhcqk,bckhd->bcqhd', p, vb)
    return out.reshape(b, s, h * d).astype(q.dtype)


def chunk_spatial_gating(u, v, ln_g, ln_b, w_s, b_s):
    b, s, _ = u.shape
    nb = s // B_BLOCK
    v = layer_norm(v, ln_g, ln_b)
    vg = v.reshape(b, nb, B_BLOCK, B_GROUPS, B_GROUP_DIM)
    causal = jnp.tril(jnp.ones((B_BLOCK, B_BLOCK), dtype=bool))
    w = jnp.where(causal[None], w_s, jnp.zeros_like(w_s))
    f = jnp.einsum('gts,bnsgc->bntgc', w, vg) + b_s.T[None, None, :, :, None]
    return u * f.reshape(b, s, B_WIDTH).astype(u.dtype)


def attn_gmlp_mixer(h, w_in, rel_bias, ln_g, ln_b, w_s, b_s, w_out):
    b, s, _ = h.shape
    proj = h @ w_in
    q, k, v, zu, zv = jnp.split(
        proj, [A_WIDTH, 2 * A_WIDTH, 3 * A_WIDTH, 3 * A_WIDTH + B_WIDTH], axis=-1)
    heads = lambda t: t.reshape(b, s, A_HEADS, A_HEAD_DIM)
    a_out = chunk_band_attention(heads(q), heads(k), heads(v), rel_bias)
    b_out = chunk_spatial_gating(jax.nn.gelu(zu, approximate=False),
                                 jax.nn.gelu(zv, approximate=False),
                                 ln_g, ln_b, w_s, b_s)
    return jnp.concatenate([a_out, b_out], axis=-1) @ w_out


def gla_chunk_scan(q, k, v, log_a):
    b, s, h, dk = q.shape
    dv = v.shape[-1]
    nc = s // CHUNK

    def to_chunks(t):
        return t.reshape(b, nc, CHUNK, h, t.shape[-1]).transpose(1, 0, 3, 2, 4)

    causal = jnp.tril(jnp.ones((CHUNK, CHUNK), dtype=bool))[:, :, None]

    def step(state, inp):
        qc, kc, vc, lac = inp
        cum = jnp.cumsum(lac, axis=2)
        diff = cum[:, :, :, None, :] - cum[:, :, None, :, :]
        decay = jnp.exp(jnp.where(causal, diff, -jnp.inf))
        attn = jnp.einsum('bhid,bhjd,bhijd->bhij', qc, kc, decay)
        o = (jnp.einsum('bhij,bhje->bhie', attn, vc)
             + jnp.einsum('bhid,bhde->bhie', qc * jnp.exp(cum), state))
        last = cum[:, :, -1:, :]
        state = (jnp.exp(last[:, :, 0, :])[..., None] * state
                 + jnp.einsum('bhjd,bhje->bhde', kc * jnp.exp(last - cum), vc))
        return state, o

    s0 = jnp.zeros((b, h, dk, dv), jnp.float32)
    _, o = lax.scan(step, s0, (to_chunks(q), to_chunks(k), to_chunks(v), to_chunks(log_a)))
    return o.transpose(1, 0, 3, 2, 4).reshape(b, s, h, dv)


def gla_mixer(h, w_in, w_a2, b_a, norm_g, w_out):
    b, s, _ = h.shape
    proj = h @ w_in
    q, k, v, g, a_low = jnp.split(
        proj, [C_KEY_DIM, 2 * C_KEY_DIM, 2 * C_KEY_DIM + C_VAL_DIM,
               2 * C_KEY_DIM + 2 * C_VAL_DIM], axis=-1)
    log_a = jax.nn.log_sigmoid((a_low @ w_a2 + b_a).astype(jnp.float32)) / C_GATE_TAU
    heads = lambda t, d: t.reshape(b, s, C_HEADS, d).astype(jnp.float32)
    o = gla_chunk_scan(heads(q, C_DK) * (C_DK ** -0.5), heads(k, C_DK),
                       heads(v, C_DV), heads(log_a, C_DK))
    o = rms_norm(o, norm_g.reshape(C_HEADS, C_DV))
    o = o.reshape(b, s, C_VAL_DIM).astype(h.dtype) * jax.nn.silu(g)
    return o @ w_out


def swiglu(h, w_gate, w_up, w_down):
    return (jax.nn.silu(h @ w_gate) * (h @ w_up)) @ w_down


def setup_inputs(seed: int = 0) -> dict:
    key = jax.random.key(seed)
    ks = jax.random.split(key, 24)
    f32 = jnp.float32
    nrm = lambda k, shape, scale: jax.random.normal(k, shape, f32) * scale
    return {
        "x": nrm(ks[0], (BATCH, SEQ, D_MODEL), 1.0),
        "pre_mix_g": 1.0 + nrm(ks[1], (DEPTH, D_MODEL), 0.05),
        "post_mix_g": 1.0 + nrm(ks[2], (DEPTH, D_MODEL), 0.05),
        "pre_ffn_g": 1.0 + nrm(ks[3], (DEPTH, D_MODEL), 0.05),
        "post_ffn_g": 1.0 + nrm(ks[4], (DEPTH, D_MODEL), 0.05),
        "ab_w_in": nrm(ks[5], (N_EVEN, D_MODEL, AB_IN), D_MODEL ** -0.5),
        "a_rel_bias": nrm(ks[6], (N_EVEN, A_HEADS, 2 * A_MAX_REL + 1), 0.5),
        "b_ln_g": 1.0 + nrm(ks[7], (N_EVEN, B_WIDTH), 0.05),
        "b_ln_b": nrm(ks[8], (N_EVEN, B_WIDTH), 0.05),
        "b_w_s": nrm(ks[9], (N_EVEN, B_GROUPS, B_BLOCK, B_BLOCK), B_BLOCK ** -0.5),
        "b_b_s": 1.0 + nrm(ks[10], (N_EVEN, B_GROUPS, B_BLOCK), 0.1),
        "ab_w_out": nrm(ks[11], (N_EVEN, AB_MIX, D_MODEL), AB_MIX ** -0.5),
        "c_w_in": nrm(ks[12], (N_ODD, D_MODEL, C_IN), D_MODEL ** -0.5),
        "c_w_a2": nrm(ks[13], (N_ODD, C_GATE_RANK, C_KEY_DIM), C_GATE_RANK ** -0.5),
        "c_b_a": nrm(ks[14], (N_ODD, C_KEY_DIM), 0.1),
        "c_norm_g": 1.0 + nrm(ks[15], (N_ODD, C_VAL_DIM), 0.05),
        "c_w_out": nrm(ks[16], (N_ODD, C_VAL_DIM, D_MODEL), C_VAL_DIM ** -0.5),
        "ffn_w_gate": nrm(ks[17], (DEPTH, D_MODEL, D_FF), D_MODEL ** -0.5),
        "ffn_w_up": nrm(ks[18], (DEPTH, D_MODEL, D_FF), D_MODEL ** -0.5),
        "ffn_w_down": nrm(ks[19], (DEPTH, D_FF, D_MODEL), D_FF ** -0.5),
    }


def reference(x, pre_mix_g, post_mix_g, pre_ffn_g, post_ffn_g,
              ab_w_in, a_rel_bias, b_ln_g, b_ln_b, b_w_s, b_b_s, ab_w_out,
              c_w_in, c_w_a2, c_b_a, c_norm_g, c_w_out,
              ffn_w_gate, ffn_w_up, ffn_w_down):
    for i in range(DEPTH):
        j = i // 2
        h = rms_norm(x, pre_mix_g[i])
        if i % 2 == 0:
            m = attn_gmlp_mixer(h, ab_w_in[j], a_rel_bias[j], b_ln_g[j], b_ln_b[j],
                                b_w_s[j], b_b_s[j], ab_w_out[j])
        else:
            m = gla_mixer(h, c_w_in[j], c_w_a2[j], c_b_a[j], c_norm_g[j], c_w_out[j])
        x = x + rms_norm(m, post_mix_g[i])
        h = rms_norm(x, pre_ffn_g[i])
        x = x + rms_norm(swiglu(h, ffn_w_gate[i], ffn_w_up[i], ffn_w_down[i]), post_ffn_g[i])
    return x
```

```cpp
#include <hip/hip_runtime.h>
#include <cstdio>
#include <cstdint>

typedef unsigned short bf16_t;
typedef short bf16x8 __attribute__((ext_vector_type(8)));
typedef float f32x4 __attribute__((ext_vector_type(4)));

namespace cfg {
constexpr int D = 1024, BATCH = 4, SEQ = 8192, M = BATCH * SEQ;
constexpr int NREL = 513;
constexpr int AB_IN = 2560;
constexpr int C_IN = 3088, C_INF = 3584;
constexpr int FF = 2816, FF2 = 5632;
constexpr float EPS = 1e-6f;
constexpr float LOG2E = 1.4426950408889634f;
constexpr size_t MiB = 1u << 20;
constexpr size_t WS_CTL = 0;
constexpr size_t WS_SSQ = 1 * MiB;
constexpr size_t WS_WIN0 = 4 * MiB, WS_WOUT0 = 9 * MiB, WS_WGU0 = 11 * MiB, WS_WDN0 = 22 * MiB;
constexpr size_t WS_WIN1 = 28 * MiB, WS_WOUT1 = 35 * MiB, WS_WGU1 = 37 * MiB, WS_WDN1 = 48 * MiB;
constexpr size_t WS_XB = 64 * MiB;
constexpr size_t WS_PB = 128 * MiB;
constexpr size_t WS_HID = 128 * MiB;
constexpr size_t WS_MIX = 352 * MiB;
constexpr size_t WS_TMPA = 128 * MiB;
constexpr size_t WS_TMPB = 352 * MiB;
constexpr size_t WS_END = 512 * MiB;
}
using namespace cfg;

__device__ __forceinline__ float bf2f(bf16_t v) { return __uint_as_float(((unsigned)v) << 16); }
__device__ __forceinline__ bf16_t f2bf(float f) { unsigned u = __float_as_uint(f); return (bf16_t)((u + 0x7fffu + ((u >> 16) & 1u)) >> 16); }
__device__ __forceinline__ unsigned pk2(float lo, float hi) { return (unsigned)f2bf(lo) | ((unsigned)f2bf(hi) << 16); }
__device__ __forceinline__ float wave_sum(float v) {
#pragma unroll
    for (int o = 1; o < 64; o <<= 1) v += __shfl_xor(v, o);
    return v;
}
__device__ __forceinline__ float gelu_exact(float v) { return 0.5f * v * (1.0f + erff(v * 0.70710678118654752f)); }
__device__ __forceinline__ float silu_f(float v) { return v / (1.0f + __expf(-v)); }
__device__ __forceinline__ float logsigmoid_f(float z) { return fminf(z, 0.f) - log1pf(__expf(-fabsf(z))); }

__global__ void k_wprep(const float* __restrict__ src, int ld, int scol0, int K, const float* __restrict__ g, bf16_t* __restrict__ dst, int drow0) {
    __shared__ float tile[32][33];
    const int n0 = blockIdx.x * 32, k0 = blockIdx.y * 32, tx = threadIdx.x, ty = threadIdx.y;
#pragma unroll
    for (int i = 0; i < 4; ++i) { const int kk = ty + 8 * i; tile[kk][tx] = src[(size_t)(k0 + kk) * ld + scol0 + n0 + tx] * (g ? g[k0 + kk] : 1.0f); }
    __syncthreads();
#pragma unroll
    for (int i = 0; i < 4; ++i) { const int nn = ty + 8 * i; dst[(size_t)(drow0 + n0 + nn) * K + k0 + tx] = f2bf(tile[tx][nn]); }
}
__global__ void k_wprep_gu(const float* __restrict__ wg, const float* __restrict__ wu, const float* __restrict__ g, bf16_t* __restrict__ dst) {
    __shared__ float tile[32][33];
    const int n0 = blockIdx.x * 32, k0 = blockIdx.y * 32, tx = threadIdx.x, ty = threadIdx.y;
    const int t = n0 / 256, j = n0 % 256; const float* src = (j < 128) ? wg : wu; const int scol = 128 * t + (j & 127);
#pragma unroll
    for (int i = 0; i < 4; ++i) { const int kk = ty + 8 * i; tile[kk][tx] = src[(size_t)(k0 + kk) * FF + scol + tx] * g[k0 + kk]; }
    __syncthreads();
#pragma unroll
    for (int i = 0; i < 4; ++i) { const int nn = ty + 8 * i; dst[(size_t)(n0 + nn) * D + k0 + tx] = f2bf(tile[tx][nn]); }
}
__global__ void k_wcomb(const float* __restrict__ w_in, const float* __restrict__ w_a2, const float* __restrict__ g, bf16_t* __restrict__ dst) {
    const int idx = blockIdx.x * blockDim.x + threadIdx.x; const int k = idx & 1023, n = idx >> 10;
    float s = 0.f;
#pragma unroll
    for (int r = 0; r < 16; ++r) s += w_in[(size_t)k * C_IN + 3072 + r] * w_a2[r * 512 + n];
    dst[(size_t)(3072 + n) * D + k] = f2bf(s * g[k]);
}
__global__ void k_xprep(const float* __restrict__ x, bf16_t* __restrict__ xb, float* __restrict__ ssq) {
    const int row = blockIdx.x * 4 + (threadIdx.x >> 6), lane = threadIdx.x & 63;
    const f32x4* xr = (const f32x4*)(x + (size_t)row * D) + lane; float s = 0.f;
    unsigned long long* o8 = (unsigned long long*)(xb + (size_t)row * D) + lane;
#pragma unroll
    for (int j = 0; j < 4; ++j) { const f32x4 v = xr[64 * j]; s += (v.x * v.x + v.y * v.y) + (v.z * v.z + v.w * v.w);
        o8[64 * j] = (unsigned long long)pk2(v.x, v.y) | ((unsigned long long)pk2(v.z, v.w) << 32); }
    s = wave_sum(s);
    if (lane == 0) { f32x4 o = {s, 0.f, 0.f, 0.f}; *(f32x4*)(ssq + 4 * (size_t)row) = o; }
}

enum { MODE_IN0 = 0, MODE_F32 = 1, MODE_GU = 2, MODE_IN1 = 3 };
struct GemmP { const bf16_t* A; const bf16_t* Bt; int N, K; const float* ssq; bf16_t* outb; float* outf; const float* bias; };

template <int MODE> __global__ __launch_bounds__(256) void k_gemm(GemmP p) {
    constexpr int NB = (MODE == MODE_GU) ? 2 : 1;
    const int lane = threadIdx.x & 63, wid = threadIdx.x >> 6, fr = lane & 15, fq = lane >> 4;
    const int m0 = blockIdx.y * 128 + (wid >> 1) * 64, c0 = blockIdx.x * 128 + (wid & 1) * 64;
    int nb[NB];
    if (MODE == MODE_GU) { nb[0] = 256 * (c0 / 128) + (c0 % 128); nb[NB - 1] = nb[0] + 128; } else nb[0] = c0;
    const int K = p.K;
    f32x4 acc[NB][4][4];
#pragma unroll
    for (int s = 0; s < NB; ++s)
#pragma unroll
        for (int i = 0; i < 4; ++i)
#pragma unroll
            for (int j = 0; j < 4; ++j) acc[s][i][j] = (f32x4){0.f, 0.f, 0.f, 0.f};
    const bf16_t* Ap = p.A + (size_t)(m0 + fr) * K + 8 * fq;
    const bf16_t* Bp[NB];
#pragma unroll
    for (int s = 0; s < NB; ++s) Bp[s] = p.Bt + (size_t)(nb[s] + fr) * K + 8 * fq;
    for (int k0 = 0; k0 < K; k0 += 32) {
        bf16x8 a[4], b[NB][4];
#pragma unroll
        for (int i = 0; i < 4; ++i) a[i] = *(const bf16x8*)(Ap + (size_t)(16 * i) * K + k0);
#pragma unroll
        for (int s = 0; s < NB; ++s)
#pragma unroll
            for (int j = 0; j < 4; ++j) b[s][j] = *(const bf16x8*)(Bp[s] + (size_t)(16 * j) * K + k0);
#pragma unroll
        for (int s = 0; s < NB; ++s)
#pragma unroll
            for (int i = 0; i < 4; ++i)
#pragma unroll
                for (int j = 0; j < 4; ++j) acc[s][i][j] = __builtin_amdgcn_mfma_f32_16x16x32_bf16(b[s][j], a[i], acc[s][i][j], 0, 0, 0);
    }
#pragma unroll
    for (int i = 0; i < 4; ++i) {
        const int row = m0 + 16 * i + fr;
        float rs = 1.f;
        if (MODE != MODE_F32) { const f32x4 q = *(const f32x4*)(p.ssq + 4 * (size_t)row); rs = rsqrtf(((q.x + q.y) + (q.z + q.w)) * (1.0f / D) + EPS); }
#pragma unroll
        for (int j = 0; j < 4; ++j) {
            const int col = c0 + 16 * j + 4 * fq;
            f32x4 v = acc[0][i][j];
            if (MODE == MODE_F32) { *(f32x4*)(p.outf + (size_t)row * p.N + col) = v; continue; }
            v = v * rs;
            if (MODE == MODE_IN0) {
                if (col < 512) v = v * (0.125f * LOG2E);
                else if (col >= 1536) { v.x = gelu_exact(v.x); v.y = gelu_exact(v.y); v.z = gelu_exact(v.z); v.w = gelu_exact(v.w); }
                *(uint2*)(p.outb + (size_t)row * AB_IN + col) = make_uint2(pk2(v.x, v.y), pk2(v.z, v.w));
            } else if (MODE == MODE_GU) {
                const f32x4 u = acc[NB - 1][i][j] * rs;
                v.x = silu_f(v.x) * u.x; v.y = silu_f(v.y) * u.y; v.z = silu_f(v.z) * u.z; v.w = silu_f(v.w) * u.w;
                *(uint2*)(p.outb + (size_t)row * FF + col) = make_uint2(pk2(v.x, v.y), pk2(v.z, v.w));
            } else {
                if (col < 512) v = v * 0.08838834764831845f;
                else if (col >= 2048 && col < 3072) { v.x = silu_f(v.x); v.y = silu_f(v.y); v.z = silu_f(v.z); v.w = silu_f(v.w); }
                else if (col >= 3072) { const f32x4 bb = *(const f32x4*)(p.bias + (col - 3072));
                    v.x = logsigmoid_f(v.x + bb.x) * 0.0625f; v.y = logsigmoid_f(v.y + bb.y) * 0.0625f; v.z = logsigmoid_f(v.z + bb.z) * 0.0625f; v.w = logsigmoid_f(v.w + bb.w) * 0.0625f; }
                *(uint2*)(p.outb + (size_t)row * C_INF + col) = make_uint2(pk2(v.x, v.y), pk2(v.z, v.w));
            }
        }
    }
}

__global__ void k_rowpost(const float* __restrict__ tmp, const float* base, const float* __restrict__ g, float* out, bf16_t* __restrict__ xb, float* __restrict__ ssq) {
    const int row = blockIdx.x * 4 + (threadIdx.x >> 6), lane = threadIdx.x & 63;
    const f32x4* tr = (const f32x4*)(tmp + (size_t)row * D) + lane; const f32x4* br = (const f32x4*)(base + (size_t)row * D) + lane; const f32x4* gr = (const f32x4*)g + lane;
    f32x4 t[4]; float s = 0.f;
#pragma unroll
    for (int j = 0; j < 4; ++j) { t[j] = tr[64 * j]; s += (t[j].x * t[j].x + t[j].y * t[j].y) + (t[j].z * t[j].z + t[j].w * t[j].w); }
    const float rm = rsqrtf(wave_sum(s) * (1.0f / D) + EPS); float s2 = 0.f;
    f32x4* orow = (f32x4*)(out + (size_t)row * D) + lane; unsigned long long* o8 = (unsigned long long*)(xb + (size_t)row * D) + lane;
#pragma unroll
    for (int j = 0; j < 4; ++j) { const f32x4 v = br[64 * j] + t[j] * rm * gr[64 * j]; s2 += (v.x * v.x + v.y * v.y) + (v.z * v.z + v.w * v.w);
        orow[64 * j] = v; o8[64 * j] = (unsigned long long)pk2(v.x, v.y) | ((unsigned long long)pk2(v.z, v.w) << 32); }
    s2 = wave_sum(s2);
    if (lane == 0) { f32x4 o = {s2, 0.f, 0.f, 0.f}; *(f32x4*)(ssq + 4 * (size_t)row) = o; }
}

__global__ __launch_bounds__(64) void k_attn(const bf16_t* __restrict__ pb, const float* __restrict__ relb, bf16_t* __restrict__ mix) {
    const int item = blockIdx.x, c = item & 127, h = (item >> 7) & 7, b = item >> 10, lane = threadIdx.x;
    const size_t qrow = (size_t)b * SEQ + c * 64 + lane;
    float q[64], o[64];
    { const uint4* qp = (const uint4*)(pb + qrow * AB_IN + h * 64);
#pragma unroll
      for (int i = 0; i < 8; ++i) { const uint4 w = qp[i]; q[8*i+0] = __uint_as_float(w.x << 16); q[8*i+1] = __uint_as_float(w.x & 0xffff0000u); q[8*i+2] = __uint_as_float(w.y << 16); q[8*i+3] = __uint_as_float(w.y & 0xffff0000u);
          q[8*i+4] = __uint_as_float(w.z << 16); q[8*i+5] = __uint_as_float(w.z & 0xffff0000u); q[8*i+6] = __uint_as_float(w.w << 16); q[8*i+7] = __uint_as_float(w.w & 0xffff0000u); } }
#pragma unroll
    for (int d = 0; d < 64; ++d) o[d] = 0.f;
    float m = -1e30f, l = 0.f;
    const float* rb = relb + h * NREL;
    const int kc0 = (c >= 8) ? c - 8 : 0;
    for (int kc = kc0; kc <= c; ++kc) {
        for (int j = 0; j < 64; ++j) {
            const size_t krow = (size_t)b * SEQ + kc * 64 + j;
            const uint4* kp = (const uint4*)(pb + krow * AB_IN + 512 + h * 64); const uint4* vp = (const uint4*)(pb + krow * AB_IN + 1024 + h * 64);
            float s = 0.f;
#pragma unroll
            for (int i = 0; i < 8; ++i) { const uint4 w = kp[i];
                s += q[8*i+0] * __uint_as_float(w.x << 16) + q[8*i+1] * __uint_as_float(w.x & 0xffff0000u) + q[8*i+2] * __uint_as_float(w.y << 16) + q[8*i+3] * __uint_as_float(w.y & 0xffff0000u)
                   + q[8*i+4] * __uint_as_float(w.z << 16) + q[8*i+5] * __uint_as_float(w.z & 0xffff0000u) + q[8*i+6] * __uint_as_float(w.w << 16) + q[8*i+7] * __uint_as_float(w.w & 0xffff0000u); }
            int rel = (c * 64 + lane) - (kc * 64 + j); rel = rel < -256 ? -256 : (rel > 256 ? 256 : rel);
            s += rb[rel + 256] * LOG2E;
            const float mn = fmaxf(m, s), alpha = exp2f(m - mn), pp = exp2f(s - mn);
            l = l * alpha + pp; m = mn;
#pragma unroll
            for (int i = 0; i < 8; ++i) { const uint4 w = vp[i];
                o[8*i+0] = o[8*i+0] * alpha + pp * __uint_as_float(w.x << 16); o[8*i+1] = o[8*i+1] * alpha + pp * __uint_as_float(w.x & 0xffff0000u);
                o[8*i+2] = o[8*i+2] * alpha + pp * __uint_as_float(w.y << 16); o[8*i+3] = o[8*i+3] * alpha + pp * __uint_as_float(w.y & 0xffff0000u);
                o[8*i+4] = o[8*i+4] * alpha + pp * __uint_as_float(w.z << 16); o[8*i+5] = o[8*i+5] * alpha + pp * __uint_as_float(w.z & 0xffff0000u);
                o[8*i+6] = o[8*i+6] * alpha + pp * __uint_as_float(w.w << 16); o[8*i+7] = o[8*i+7] * alpha + pp * __uint_as_float(w.w & 0xffff0000u); }
        }
    }
    const float rl = 1.0f / l;
    uint4* op = (uint4*)(mix + qrow * D + h * 64);
#pragma unroll
    for (int i = 0; i < 8; ++i) op[i] = make_uint4(pk2(o[8*i] * rl, o[8*i+1] * rl), pk2(o[8*i+2] * rl, o[8*i+3] * rl), pk2(o[8*i+4] * rl, o[8*i+5] * rl), pk2(o[8*i+6] * rl, o[8*i+7] * rl));
}

__global__ __launch_bounds__(256) void k_gate(const bf16_t* __restrict__ pb, const float* __restrict__ ln_g, const float* __restrict__ ln_b, const float* __restrict__ w_s, const float* __restrict__ b_s, bf16_t* __restrict__ mix) {
    __shared__ float vln[128 * 128];
    const int g = blockIdx.x & 3, blk = blockIdx.x >> 2, tid = threadIdx.x, lane = tid & 63, wid = tid >> 6;
    const size_t row0 = (size_t)blk * 128;
    for (int r = wid * 32; r < wid * 32 + 32; ++r) {
        const uint4 w = *(const uint4*)(pb + (row0 + r) * AB_IN + 2048 + lane * 8);
        float v[8] = { __uint_as_float(w.x << 16), __uint_as_float(w.x & 0xffff0000u), __uint_as_float(w.y << 16), __uint_as_float(w.y & 0xffff0000u),
                       __uint_as_float(w.z << 16), __uint_as_float(w.z & 0xffff0000u), __uint_as_float(w.w << 16), __uint_as_float(w.w & 0xffff0000u) };
        float s = 0.f;
#pragma unroll
        for (int i = 0; i < 8; ++i) s += v[i];
        const float mu = wave_sum(s) * (1.0f / 512.0f); float s2 = 0.f;
#pragma unroll
        for (int i = 0; i < 8; ++i) { v[i] -= mu; s2 += v[i] * v[i]; }
        const float rstd = rsqrtf(wave_sum(s2) * (1.0f / 512.0f) + EPS);
        if ((lane >> 4) == g) {
#pragma unroll
            for (int i = 0; i < 8; ++i) { const int col = lane * 8 + i; vln[r * 128 + (col & 127)] = v[i] * rstd * ln_g[col] + ln_b[col]; }
        }
    }
    __syncthreads();
    const int cc = tid & 127, th = tid >> 7;
    const float* wg = w_s + (size_t)g * 128 * 128;
    for (int t = th; t < 128; t += 2) {
        float f = 0.f;
        for (int s = 0; s <= t; ++s) f += wg[t * 128 + s] * vln[s * 128 + cc];
        f += b_s[g * 128 + t];
        const float u = bf2f(pb[(row0 + t) * AB_IN + 1536 + g * 128 + cc]);
        mix[(row0 + t) * D + 512 + g * 128 + cc] = f2bf(u * f);
    }
}

__global__ __launch_bounds__(512) void k_gla(const bf16_t* __restrict__ pb, const float* __restrict__ norm_g, bf16_t* __restrict__ mix) {
    constexpr int TB = 8;
    __shared__ float qs[TB][128], ks[TB][128], av[TB][128], vs[TB][256], part[TB][2][256];
    const int b = blockIdx.x >> 2, h = blockIdx.x & 3, tid = threadIdx.x, e = tid & 255, dh = tid >> 8, lane = tid & 63, wid = tid >> 6;
    float S[64];
#pragma unroll
    for (int d = 0; d < 64; ++d) S[d] = 0.f;
    const float ng = norm_g[h * 256 + e];
    for (int t0 = 0; t0 < SEQ; t0 += TB) {
        const size_t rowb = (size_t)b * SEQ + t0;
        for (int i = tid; i < TB * 128; i += 512) { const int tt = i >> 7, d = i & 127; const bf16_t* r = pb + (rowb + tt) * C_INF;
            qs[tt][d] = bf2f(r[h * 128 + d]); ks[tt][d] = bf2f(r[512 + h * 128 + d]); av[tt][d] = __expf(bf2f(r[3072 + h * 128 + d])); }
        for (int i = tid; i < TB * 256; i += 512) { const int tt = i >> 8, ee = i & 255; vs[tt][ee] = bf2f(pb[(rowb + tt) * C_INF + 1024 + h * 256 + ee]); }
        __syncthreads();
        for (int tt = 0; tt < TB; ++tt) {
            const float v = vs[tt][e]; float po = 0.f;
#pragma unroll
            for (int d = 0; d < 64; ++d) { S[d] = av[tt][dh * 64 + d] * S[d] + ks[tt][dh * 64 + d] * v; po += qs[tt][dh * 64 + d] * S[d]; }
            part[tt][dh][e] = po;
        }
        __syncthreads();
        for (int tt = wid; tt < wid + 1; ++tt) {
            float ov[4]; float ss = 0.f;
#pragma unroll
            for (int i = 0; i < 4; ++i) { const int ee = lane + 64 * i; ov[i] = part[tt][0][ee] + part[tt][1][ee]; ss += ov[i] * ov[i]; }
            const float rstd = rsqrtf(wave_sum(ss) * (1.0f / 256.0f) + EPS);
#pragma unroll
            for (int i = 0; i < 4; ++i) { const int ee = lane + 64 * i; const size_t row = rowb + tt;
                const float sg = bf2f(pb[row * C_INF + 2048 + h * 256 + ee]);
                mix[row * D + h * 256 + ee] = f2bf(ov[i] * rstd * norm_g[h * 256 + ee] * sg); }
        }
        __syncthreads();
    }
    (void)ng;
}

extern "C" void kernel_launch(void* const* d_in, const int* in_sizes, int n_in, void* d_out, int out_size, void* d_ws, size_t ws_size, hipStream_t stream) {
    if (n_in != 20 || in_sizes[0] != M * D || out_size != M * D || ws_size < WS_END) { fprintf(stderr, "kernel_launch: unexpected shapes (n_in %d, in0 %d, out %d, ws %zu)\n", n_in, n_in > 0 ? in_sizes[0] : -1, out_size, ws_size); return; }
    const float* x = (const float*)d_in[0]; const float* pre_mix_g = (const float*)d_in[1]; const float* post_mix_g = (const float*)d_in[2]; const float* pre_ffn_g = (const float*)d_in[3]; const float* post_ffn_g = (const float*)d_in[4];
    const float* ab_w_in = (const float*)d_in[5]; const float* a_rel_bias = (const float*)d_in[6]; const float* b_ln_g = (const float*)d_in[7]; const float* b_ln_b = (const float*)d_in[8]; const float* b_w_s = (const float*)d_in[9]; const float* b_b_s = (const float*)d_in[10];
    const float* ab_w_out = (const float*)d_in[11]; const float* c_w_in = (const float*)d_in[12]; const float* c_w_a2 = (const float*)d_in[13]; const float* c_b_a = (const float*)d_in[14]; const float* c_norm_g = (const float*)d_in[15]; const float* c_w_out = (const float*)d_in[16];
    const float* ffn_w_gate = (const float*)d_in[17]; const float* ffn_w_up = (const float*)d_in[18]; const float* ffn_w_down = (const float*)d_in[19];
    unsigned char* ws = (unsigned char*)d_ws; float* out = (float*)d_out;
    float* ssq = (float*)(ws + WS_SSQ);
    bf16_t *win0 = (bf16_t*)(ws + WS_WIN0), *wout0 = (bf16_t*)(ws + WS_WOUT0), *wgu0 = (bf16_t*)(ws + WS_WGU0), *wdn0 = (bf16_t*)(ws + WS_WDN0);
    bf16_t *win1 = (bf16_t*)(ws + WS_WIN1), *wout1 = (bf16_t*)(ws + WS_WOUT1), *wgu1 = (bf16_t*)(ws + WS_WGU1), *wdn1 = (bf16_t*)(ws + WS_WDN1);
    bf16_t *xb = (bf16_t*)(ws + WS_XB), *pb = (bf16_t*)(ws + WS_PB), *hid = (bf16_t*)(ws + WS_HID), *mix = (bf16_t*)(ws + WS_MIX);
    float *tmpa = (float*)(ws + WS_TMPA), *tmpb = (float*)(ws + WS_TMPB);
    const dim3 tb(32, 8);
    k_wprep<<<dim3(AB_IN / 32, D / 32), tb, 0, stream>>>(ab_w_in, AB_IN, 0, D, pre_mix_g, win0, 0);
    k_wprep<<<dim3(D / 32, D / 32), tb, 0, stream>>>(ab_w_out, D, 0, D, nullptr, wout0, 0);
    k_wprep_gu<<<dim3(FF2 / 32, D / 32), tb, 0, stream>>>(ffn_w_gate, ffn_w_up, pre_ffn_g, wgu0);
    k_wprep<<<dim3(D / 32, FF / 32), tb, 0, stream>>>(ffn_w_down, D, 0, FF, nullptr, wdn0, 0);
    k_wprep<<<dim3(3072 / 32, D / 32), tb, 0, stream>>>(c_w_in, C_IN, 0, D, pre_mix_g + D, win1, 0);
    k_wcomb<<<dim3(512 * 1024 / 256), 256, 0, stream>>>(c_w_in, c_w_a2, pre_mix_g + D, win1);
    k_wprep<<<dim3(D / 32, D / 32), tb, 0, stream>>>(c_w_out, D, 0, D, nullptr, wout1, 0);
    k_wprep_gu<<<dim3(FF2 / 32, D / 32), tb, 0, stream>>>(ffn_w_gate + (size_t)D * FF, ffn_w_up + (size_t)D * FF, pre_ffn_g + D, wgu1);
    k_wprep<<<dim3(D / 32, FF / 32), tb, 0, stream>>>(ffn_w_down + (size_t)FF * D, D, 0, FF, nullptr, wdn1, 0);
    k_xprep<<<M / 4, 256, 0, stream>>>(x, xb, ssq);
    { GemmP p{xb, win0, AB_IN, D, ssq, pb, nullptr, nullptr}; k_gemm<MODE_IN0><<<dim3(AB_IN / 128, M / 128), 256, 0, stream>>>(p); }
    k_attn<<<4 * 8 * 128, 64, 0, stream>>>(pb, a_rel_bias, mix);
    k_gate<<<(M / 128) * 4, 256, 0, stream>>>(pb, b_ln_g, b_ln_b, b_w_s, b_b_s, mix);
    { GemmP p{mix, wout0, D, D, nullptr, nullptr, tmpa, nullptr}; k_gemm<MODE_F32><<<dim3(D / 128, M / 128), 256, 0, stream>>>(p); }
    k_rowpost<<<M / 4, 256, 0, stream>>>(tmpa, x, post_mix_g, out, xb, ssq);
    { GemmP p{xb, wgu0, FF, D, ssq, hid, nullptr, nullptr}; k_gemm<MODE_GU><<<dim3(FF / 128, M / 128), 256, 0, stream>>>(p); }
    { GemmP p{hid, wdn0, D, FF, nullptr, nullptr, tmpb, nullptr}; k_gemm<MODE_F32><<<dim3(D / 128, M / 128), 256, 0, stream>>>(p); }
    k_rowpost<<<M / 4, 256, 0, stream>>>(tmpb, out, post_ffn_g, out, xb, ssq);
    { GemmP p{xb, win1, C_INF, D, ssq, pb, nullptr, c_b_a}; k_gemm<MODE_IN1><<<dim3(C_INF / 128, M / 128), 256, 0, stream>>>(p); }
    k_gla<<<16, 512, 0, stream>>>(pb, c_norm_g, mix);
    { GemmP p{mix, wout1, D, D, nullptr, nullptr, tmpa, nullptr}; k_gemm<MODE_F32><<<dim3(D / 128, M / 128), 256, 0, stream>>>(p); }
    k_rowpost<<<M / 4, 256, 0, stream>>>(tmpa, out, post_mix_g + D, out, xb, ssq);
    { GemmP p{xb, wgu1, FF, D, ssq, hid, nullptr, nullptr}; k_gemm<MODE_GU><<<dim3(FF / 128, M / 128), 256, 0, stream>>>(p); }
    { GemmP p{hid, wdn1, D, FF, nullptr, nullptr, tmpb, nullptr}; k_gemm<MODE_F32><<<dim3(D / 128, M / 128), 256, 0, stream>>>(p); }
    k_rowpost<<<M / 4, 256, 0, stream>>>(tmpb, out, post_ffn_g + D, out, xb, ssq);
}
```
